# Optimizing an MI355X kernel written in HIP

```python
import jax, jax.numpy as jnp
from jax import lax
import numpy as np

D_MODEL = 1024
BATCH = 8
SEQ = 2048
DEPTH = 2
DEC_BATCH = 128
DEC_SEQ = 8
PAST_LEN = 16384
PAGE_SIZE = 128

N_EVEN = (DEPTH + 1) // 2
N_ODD = DEPTH // 2
D_POOL = D_MODEL // 2
POOL_WINDOWS = (2, 4, 8, 16)
N_POOL_GROUPS = len(POOL_WINDOWS)
POOL_GROUP_DIM = D_POOL // N_POOL_GROUPS
POOL_BUF = max(POOL_WINDOWS) - 1
D_DW = D_MODEL // 2
DW_WIDTH = 31
D_SC = D_MODEL
SC_WIDTH = 3
D_FF = 2816
PLE_DIM = 256
NORM_EPS = 1e-6
LN_EPS = 1e-5

kernel_name = "hybrid_pool_conformer_shortconv_decoder_step"


def rmsnorm(x, g):
    xf = x.astype(jnp.float32)
    inv = lax.rsqrt(jnp.mean(xf * xf, axis=-1, keepdims=True) + NORM_EPS)
    return (xf * inv * g.astype(jnp.float32)).astype(x.dtype)


def layernorm(x, g, b):
    xf = x.astype(jnp.float32)
    mu = jnp.mean(xf, axis=-1, keepdims=True)
    var = jnp.mean(jnp.square(xf - mu), axis=-1, keepdims=True)
    y = (xf - mu) * lax.rsqrt(var + LN_EPS) * g.astype(jnp.float32) + b.astype(jnp.float32)
    return y.astype(x.dtype)


def swiglu(h, w_gate_up, w_down):
    gu = h @ w_gate_up
    gate, up = gu[..., :D_FF], gu[..., D_FF:]
    return (jax.nn.silu(gate) * up) @ w_down


def causal_depthwise_conv(x, prefix, weight):
    k = weight.shape[0]
    c = x.shape[-1]
    xp = jnp.concatenate([prefix.astype(x.dtype), x], axis=1)
    y = lax.conv_general_dilated(
        xp, weight[:, None, :].astype(x.dtype), window_strides=(1,), padding='VALID',
        dimension_numbers=('NWC', 'WIO', 'NWC'), feature_group_count=c)
    return y, xp[:, xp.shape[1] - (k - 1):]


def causal_multiscale_pool(x, prefix, start):
    b, s, c = x.shape
    xcat = jnp.concatenate([prefix.astype(x.dtype), x], axis=1)
    xf = xcat.astype(jnp.float32)
    cs = jnp.concatenate([jnp.zeros((b, 1, c), jnp.float32), jnp.cumsum(xf, axis=1)], axis=1)
    end = cs[:, POOL_BUF + 1:POOL_BUF + 1 + s]
    cur = xf[:, POOL_BUF:]
    pos = start + jnp.arange(s, dtype=jnp.int32)
    outs = []
    for g, w in enumerate(POOL_WINDOWS):
        lo, hi = g * POOL_GROUP_DIM, (g + 1) * POOL_GROUP_DIM
        beg = cs[:, POOL_BUF + 1 - w:POOL_BUF + 1 - w + s, lo:hi]
        cnt = jnp.minimum(w, pos + 1).astype(jnp.float32)[None, :, None]
        outs.append((end[..., lo:hi] - beg) / cnt - cur[..., lo:hi])
    pooled = jnp.concatenate(outs, axis=-1).astype(x.dtype)
    return pooled, xcat[:, xcat.shape[1] - POOL_BUF:]


def even_mixer(h, pool_prefix, dw_prefix, start, w_in, pool_proj, pool_scale,
               dw_weight, dw_bias, dw_ln_gain, dw_ln_bias, w_out):
    b, s, _ = h.shape
    proj = h @ w_in
    xa = proj[..., :D_POOL]
    va = proj[..., D_POOL:D_POOL + D_DW]
    ga = proj[..., D_POOL + D_DW:]
    pooled, new_pool = causal_multiscale_pool(xa, pool_prefix, start)
    pa = jnp.einsum('bsgc,gcd->bsgd', pooled.reshape(b, s, N_POOL_GROUPS, POOL_GROUP_DIM), pool_proj)
    pa = pa.reshape(b, s, D_POOL) * pool_scale
    u = va * jax.nn.sigmoid(ga)
    conv, new_dw = causal_depthwise_conv(u, dw_prefix, dw_weight)
    yb = jax.nn.silu(layernorm(conv + dw_bias, dw_ln_gain, dw_ln_bias))
    out = jnp.concatenate([pa, yb], axis=-1) @ w_out
    return out, new_pool, new_dw


def odd_mixer(h, sc_prefix, w_in, sc_weight, w_out):
    proj = h @ w_in
    gb = proj[..., :D_SC]
    gc = proj[..., D_SC:2 * D_SC]
    xv = proj[..., 2 * D_SC:]
    conv, new_sc = causal_depthwise_conv(gc * xv, sc_prefix, sc_weight)
    return (gb * conv) @ w_out, new_sc


def trunk(x, p, pool_states, dw_states, sc_states, start,
          norm_ffn, w_ffn_gate_up, w_ffn_down, norm_mix,
          w_in_even, pool_proj, pool_scale, dw_weight, dw_bias, dw_ln_gain, dw_ln_bias, w_out_even,
          w_in_odd, sc_weight, w_out_odd,
          norm_ple, w_ple_gate, w_ple_proj, norm_ple_proj, norm_final):
    new_pool, new_dw, new_sc = [], [], []
    for i in range(DEPTH):
        x = x + 0.5 * swiglu(rmsnorm(x, norm_ffn[i, 0]), w_ffn_gate_up[i, 0], w_ffn_down[i, 0])
        h = rmsnorm(x, norm_mix[i])
        if i % 2 == 0:
            j = i // 2
            mix, sp, sd = even_mixer(h, pool_states[j], dw_states[j], start, w_in_even[j], pool_proj[j],
                                     pool_scale[j], dw_weight[j], dw_bias[j], dw_ln_gain[j], dw_ln_bias[j],
                                     w_out_even[j])
            new_pool.append(sp)
            new_dw.append(sd)
        else:
            j = i // 2
            mix, ss = odd_mixer(h, sc_states[j], w_in_odd[j], sc_weight[j], w_out_odd[j])
            new_sc.append(ss)
        x = x + mix
        x = x + 0.5 * swiglu(rmsnorm(x, norm_ffn[i, 1]), w_ffn_gate_up[i, 1], w_ffn_down[i, 1])
        gate = jax.nn.sigmoid(rmsnorm(x, norm_ple[i]) @ w_ple_gate[i])
        emb = rmsnorm(p[i].astype(x.dtype) @ w_ple_proj[i], norm_ple_proj[i])
        x = x + gate * emb
    y = rmsnorm(x, norm_final)
    return y, jnp.stack(new_pool), jnp.stack(new_dw), jnp.stack(new_sc)


def setup_inputs(seed: int = 0) -> dict:
    key = jax.random.key(seed)
    ks = jax.random.split(key, 32)
    f32 = jnp.float32

    def nrm(k, shape, scale=1.0):
        return jax.random.normal(k, shape, f32) * scale

    def gain(k, shape):
        return 1.0 + 0.05 * jax.random.normal(k, shape, f32)

    return {
        "x_prompt": nrm(ks[0], (BATCH, SEQ, D_MODEL)),
        "x_sample": nrm(ks[1], (DEC_BATCH, DEC_SEQ, D_MODEL)),
        "state_pool": nrm(ks[2], (N_EVEN, DEC_BATCH, POOL_BUF, D_POOL)),
        "state_dwconv": nrm(ks[3], (N_EVEN, DEC_BATCH, DW_WIDTH - 1, D_DW)),
        "state_shortconv": nrm(ks[4], (N_ODD, DEC_BATCH, SC_WIDTH - 1, D_SC)),
        "p_prompt": nrm(ks[5], (DEPTH, BATCH, SEQ, PLE_DIM)),
        "p_sample": nrm(ks[6], (DEPTH, DEC_BATCH, DEC_SEQ, PLE_DIM)),
        "norm_ffn": gain(ks[7], (DEPTH, 2, D_MODEL)),
        "w_ffn_gate_up": nrm(ks[8], (DEPTH, 2, D_MODEL, 2 * D_FF), D_MODEL ** -0.5),
        "w_ffn_down": nrm(ks[9], (DEPTH, 2, D_FF, D_MODEL), D_FF ** -0.5),
        "norm_mix": gain(ks[10], (DEPTH, D_MODEL)),
        "w_in_even": nrm(ks[11], (N_EVEN, D_MODEL, D_POOL + 2 * D_DW), D_MODEL ** -0.5),
        "pool_proj": nrm(ks[12], (N_EVEN, N_POOL_GROUPS, POOL_GROUP_DIM, POOL_GROUP_DIM), POOL_GROUP_DIM ** -0.5),
        "pool_scale": gain(ks[13], (N_EVEN, D_POOL)),
        "dw_weight": nrm(ks[14], (N_EVEN, DW_WIDTH, D_DW), DW_WIDTH ** -0.5),
        "dw_bias": nrm(ks[15], (N_EVEN, D_DW), 0.02),
        "dw_ln_gain": gain(ks[16], (N_EVEN, D_DW)),
        "dw_ln_bias": nrm(ks[17], (N_EVEN, D_DW), 0.02),
        "w_out_even": nrm(ks[18], (N_EVEN, D_POOL + D_DW, D_MODEL), (D_POOL + D_DW) ** -0.5),
        "w_in_odd": nrm(ks[19], (N_ODD, D_MODEL, 3 * D_SC), D_MODEL ** -0.5),
        "sc_weight": nrm(ks[20], (N_ODD, SC_WIDTH, D_SC), SC_WIDTH ** -0.5),
        "w_out_odd": nrm(ks[21], (N_ODD, D_SC, D_MODEL), D_SC ** -0.5),
        "norm_ple": gain(ks[22], (DEPTH, D_MODEL)),
        "w_ple_gate": nrm(ks[23], (DEPTH, D_MODEL, D_MODEL), D_MODEL ** -0.5),
        "w_ple_proj": nrm(ks[24], (DEPTH, PLE_DIM, D_MODEL), PLE_DIM ** -0.5),
        "norm_ple_proj": gain(ks[25], (DEPTH, D_MODEL)),
        "norm_final": gain(ks[26], (D_MODEL,)),
    }


def reference(x_prompt, x_sample, state_pool, state_dwconv, state_shortconv, p_prompt, p_sample,
              norm_ffn, w_ffn_gate_up, w_ffn_down, norm_mix,
              w_in_even, pool_proj, pool_scale, dw_weight, dw_bias, dw_ln_gain, dw_ln_bias, w_out_even,
              w_in_odd, sc_weight, w_out_odd,
              norm_ple, w_ple_gate, w_ple_proj, norm_ple_proj, norm_final):
    weights = (norm_ffn, w_ffn_gate_up, w_ffn_down, norm_mix,
               w_in_even, pool_proj, pool_scale, dw_weight, dw_bias, dw_ln_gain, dw_ln_bias, w_out_even,
               w_in_odd, sc_weight, w_out_odd,
               norm_ple, w_ple_gate, w_ple_proj, norm_ple_proj, norm_final)
    bp = x_prompt.shape[0]
    dt = x_prompt.dtype
    zero_pool = jnp.zeros((N_EVEN, bp, POOL_BUF, D_POOL), dt)
    zero_dw = jnp.zeros((N_EVEN, bp, DW_WIDTH - 1, D_DW), dt)
    zero_sc = jnp.zeros((N_ODD, bp, SC_WIDTH - 1, D_SC), dt)
    y_prompt, pool_p, dw_p, sc_p = trunk(x_prompt, p_prompt, zero_pool, zero_dw, zero_sc, 0, *weights)
    y_sample, pool_s, dw_s, sc_s = trunk(x_sample, p_sample, state_pool, state_dwconv, state_shortconv,
                                         PAST_LEN, *weights)
    return (y_prompt, y_sample, pool_p, pool_s, dw_p, dw_s, sc_p, sc_s)
```

```cpp
#include <hip/hip_runtime.h>
#include <hip/hip_cooperative_groups.h>
#include <cstdio>
#include <cstring>
namespace cg = cooperative_groups;

#ifndef MULTI_LAUNCH
#define MULTI_LAUNCH 1
#endif

#define LAS __attribute__((address_space(3)))
typedef unsigned short bf16_t;
typedef short bf16x8 __attribute__((ext_vector_type(8)));
typedef float f32x4 __attribute__((ext_vector_type(4)));
typedef float f32x2 __attribute__((ext_vector_type(2)));
typedef unsigned u32x4 __attribute__((ext_vector_type(4)));
typedef unsigned u32x2 __attribute__((ext_vector_type(2)));

constexpr int MP = 16384;
constexpr int MS = 1024;
constexpr int M = MP + MS;
constexpr int D = 1024, FF = 2816, PLE = 256;
constexpr int SEQ = 2048, DSEQ = 8, NB_P = 8, NB_S = 128;
constexpr int PAST = 16384;
constexpr float NORM_EPS = 1e-6f, LN_EPS = 1e-5f;

constexpr size_t SZ_WGU = (size_t)2 * FF * D * 2;
constexpr size_t SZ_WD = (size_t)D * FF * 2;
constexpr size_t WS_WGU = 0;
constexpr size_t WS_WD = WS_WGU + 4 * SZ_WGU;
constexpr size_t WS_WINE = WS_WD + 4 * SZ_WD;
constexpr size_t WS_WOUTE = WS_WINE + (size_t)1536 * D * 2;
constexpr size_t WS_WINO = WS_WOUTE + (size_t)D * D * 2;
constexpr size_t WS_WOUTO = WS_WINO + (size_t)3072 * D * 2;
constexpr size_t WS_WPG = WS_WOUTO + (size_t)D * D * 2;
constexpr size_t WS_WPP = WS_WPG + (size_t)2 * D * D * 2;
constexpr size_t WS_POOLP = WS_WPP + (size_t)2 * D * PLE * 2;
constexpr size_t WS_SS = WS_POOLP + (size_t)4 * 128 * 128 * 2;
constexpr int NSS = 11;
constexpr size_t WS_XB = WS_SS + 786432;
constexpr size_t WS_PB = WS_XB + (size_t)M * D * 2;
constexpr size_t WS_E = WS_PB + (size_t)2 * M * PLE * 2;
constexpr size_t WS_ACT = WS_E + (size_t)M * D * 2;
constexpr size_t WS_PROJ = WS_ACT + (size_t)M * FF * 2;
constexpr size_t WS_END = WS_PROJ + (size_t)M * 2048 * 2;

constexpr size_t O_Y = 0;
constexpr size_t O_POOL_P = (size_t)M * D;
constexpr size_t O_POOL_S = O_POOL_P + (size_t)NB_P * 15 * 512;
constexpr size_t O_DW_P = O_POOL_S + (size_t)NB_S * 15 * 512;
constexpr size_t O_DW_S = O_DW_P + (size_t)NB_P * 30 * 512;
constexpr size_t O_SC_P = O_DW_S + (size_t)NB_S * 30 * 512;
constexpr size_t O_SC_S = O_SC_P + (size_t)NB_P * 2 * 1024;
constexpr size_t O_END = O_SC_S + (size_t)NB_S * 2 * 1024;

constexpr int LDS_BYTES = 131072;

struct Params {
    const float* in[27];
    float* out;
    unsigned char* ws;
    int ph_lo, ph_hi;
};

typedef const __attribute__((address_space(4))) Params* KP;
#define LAUNDER_S(x) asm volatile("" : "+s"(x))
#define LAUNDER_V(x) asm volatile("" : "+v"(x))

__device__ __forceinline__ Params ldp(KP pp) { Params p;
#pragma unroll
    for (int i = 0; i < 27; ++i) p.in[i] = pp->in[i];
    p.out = pp->out; p.ws = pp->ws; p.ph_lo = pp->ph_lo; p.ph_hi = pp->ph_hi; return p; }

__device__ __forceinline__ unsigned cvt_pk_bf16(float lo, float hi) { unsigned r; asm volatile("v_cvt_pk_bf16_f32 %0, %1, %2" : "=v"(r) : "v"(lo), "v"(hi)); return r; }
__device__ __forceinline__ float bf_lo(unsigned w) { return __uint_as_float(w << 16); }
__device__ __forceinline__ float bf_hi(unsigned w) { return __uint_as_float(w & 0xffff0000u); }
__device__ __forceinline__ float sigmoidf_(float x) { return __builtin_amdgcn_rcpf(1.0f + __expf(-x)); }
__device__ __forceinline__ float wave_sum(float v) {
#pragma unroll
    for (int o = 1; o < 64; o <<= 1) v += __shfl_xor(v, o);
    return v;
}
__device__ __forceinline__ u32x4 pack8(const f32x4 a, const f32x4 b) {
    u32x4 w; w.x = cvt_pk_bf16(a[0], a[1]); w.y = cvt_pk_bf16(a[2], a[3]); w.z = cvt_pk_bf16(b[0], b[1]); w.w = cvt_pk_bf16(b[2], b[3]); return w;
}

namespace pg8 {
constexpr int BM = 256, BK = 64, HALF = 128, HTB = HALF * BK * 2, STAGE_BYTES = 8 * HTB, NXCD = 8, WGM = 8;
__device__ __forceinline__ int lds_byte(int r, int c) { const int st = (r >> 4) * 2 + (c >> 5), rr = r & 15, cc = c & 31, ob = rr * 64 + cc * 2; return st * 1024 + (ob ^ (((ob >> 9) & 1) << 5)); }
__device__ __forceinline__ void stage_rc(int b, int& R, int& C) { const int st = b / 1024, sb = b % 1024, swz = sb ^ (((sb >> 9) & 1) << 5); R = (st >> 1) * 16 + swz / 64; C = (st & 1) * 32 + (swz % 64) / 2; }
__device__ __forceinline__ int perm32(int rho) { const int n = rho >> 4, i = rho & 15; return 8 * (i >> 2) + 4 * n + (i & 3); }

struct Unit { int pm, pn; };
struct Gemm { const bf16_t* A; const bf16_t* Bt; int M, N, K; };

struct StaticOrder {
    int nM, nN, nwg, G, c;
    __device__ void init(int M_, int N_, int G_, int c_) { nM = M_ / BM; nN = N_ / BM; nwg = nM * nN; G = G_; c = c_; }
    __device__ bool next(int i, Unit& u) const {
        const long L = (long)i * G + c; if (L >= nwg) return false;
        int wgid = (int)L; { const int q = nwg / NXCD, r = nwg % NXCD, xcd = wgid % NXCD, off = wgid / NXCD; wgid = (xcd < r ? xcd * (q + 1) : r * (q + 1) + (xcd - r) * q) + off; }
        const int nig = WGM * nN, gid = wgid / nig, fm = gid * WGM, gsz = (nM - fm) < WGM ? (nM - fm) : WGM;
        u.pm = fm + ((wgid % nig) % gsz); u.pn = (wgid % nig) / gsz; return true;
    }
    __device__ __forceinline__ void a_ready(const Unit&) const {}
    __device__ __forceinline__ void done(const Unit&) const {}
};

template <class Epi, class Sched>
__device__ __forceinline__ void gemm_phase(LAS unsigned char* lds, const Gemm g, const Sched& S, const Epi& E) {
    int tid_ = threadIdx.x; LAUNDER_V(tid_);
    const int tid = tid_, wid = __builtin_amdgcn_readfirstlane(tid >> 6), lane = tid & 63, wr = wid >> 2, wc = wid & 3, fr = lane & 15, fq = lane >> 4;
    int K_ = g.K; LAUNDER_S(K_);
    const int K = K_, nt = K / BK;
    unsigned voffA[2], voffB[2];
#pragma unroll
    for (int i = 0; i < 2; ++i) { int R, C; stage_rc(tid * 16 + i * 8192, R, C); const int Rb = (R & ~31) + perm32(R & 31);
        voffA[i] = (unsigned)(R * K + C) * 2u; voffB[i] = (unsigned)(Rb * K + C) * 2u; }
    const size_t kstep = (size_t)(BK * 2);
    const size_t hstep = (size_t)HALF * K * 2;
    const size_t tstep = 2 * hstep;
    const unsigned ldsw = (unsigned)wid * 1024u;
    const int aoff = lds_byte(wr * 64 + fr, fq * 8), boff = lds_byte(wc * 32 + fr, fq * 8);
#define PG8_SA(b, h) (((b) * 2 + (h)) * HTB)
#define PG8_SB(b, h) ((4 + (b) * 2 + (h)) * HTB)
#define PG8_STAGE(bufoff, gbase, voff) do { _Pragma("unroll") for (int _i = 0; _i < 2; ++_i) \
        __builtin_amdgcn_global_load_lds((const unsigned*)((const char*)(gbase) + (voff)[_i]), (LAS unsigned*)(lds + (bufoff) + ldsw + _i * 8192), 16, 0, 0); } while (0)
#define PG8_LDA(dst, b, h) do { _Pragma("unroll") for (int m = 0; m < 4; ++m) _Pragma("unroll") for (int k = 0; k < 2; ++k) dst[m][k] = *(const LAS bf16x8*)(lds + PG8_SA(b, h) + aoff + m * 2048 + k * 1024); } while (0)
#define PG8_LDB(dst, b, h) do { _Pragma("unroll") for (int n = 0; n < 2; ++n) _Pragma("unroll") for (int k = 0; k < 2; ++k) dst[n][k] = *(const LAS bf16x8*)(lds + PG8_SB(b, h) + boff + n * 2048 + k * 1024); } while (0)
#define PG8_MMA(ai, bj, At, Bt) do { __builtin_amdgcn_s_setprio(1); _Pragma("unroll") for (int m = 0; m < 4; ++m) _Pragma("unroll") for (int n = 0; n < 2; ++n) _Pragma("unroll") for (int k = 0; k < 2; ++k) \
        acc[ai][bj][m][n] = __builtin_amdgcn_mfma_f32_16x16x32_bf16(Bt[n][k], At[m][k], acc[ai][bj][m][n], 0, 0, 0); __builtin_amdgcn_s_setprio(0); } while (0)
#define PG8_WAIT_V(n) asm volatile("s_waitcnt vmcnt(" #n ")" ::: "memory")
#define PG8_WAIT_L(n) asm volatile("s_waitcnt lgkmcnt(" #n ")" ::: "memory")
#define PG8_BAR __builtin_amdgcn_s_barrier()
#define PG8_SCHED __builtin_amdgcn_sched_barrier(0)
    Unit cur, nxt; int ui = 0;
    if (!S.next(0, cur)) return;
    f32x4 acc[2][2][4][2];
#pragma unroll
    for (int a = 0; a < 2; ++a)
#pragma unroll
        for (int b = 0; b < 2; ++b)
#pragma unroll
            for (int m = 0; m < 4; ++m)
#pragma unroll
                for (int n = 0; n < 2; ++n) acc[a][b][m][n] = (f32x4){0.f, 0.f, 0.f, 0.f};
    bf16x8 At[4][2], B0[2][2], B1[2][2];
    const char* cA = (const char*)g.A + (size_t)cur.pm * tstep; const char* cB = (const char*)g.Bt + (size_t)cur.pn * tstep;
    S.a_ready(cur);
    PG8_STAGE(PG8_SB(0, 0), cB, voffB); PG8_STAGE(PG8_SA(0, 0), cA, voffA); PG8_STAGE(PG8_SB(0, 1), cB + hstep, voffB); PG8_STAGE(PG8_SA(0, 1), cA + hstep, voffA);
    if (wr == 1) PG8_BAR;
    PG8_WAIT_V(4); PG8_BAR;
    PG8_STAGE(PG8_SB(1, 0), cB + kstep, voffB); PG8_STAGE(PG8_SA(1, 0), cA + kstep, voffA); PG8_STAGE(PG8_SB(1, 1), cB + hstep + kstep, voffB);
    PG8_WAIT_V(6); PG8_BAR;
    for (;;) {
        const bool has_next = S.next(ui + 1, nxt);
        const char* nA = has_next ? (const char*)g.A + (size_t)nxt.pm * tstep : cA; const char* nB = has_next ? (const char*)g.Bt + (size_t)nxt.pn * tstep : cB;
        for (int t = 0; t < nt; t += 2) {
            const bool last = (t == nt - 2);
            const char* a1 = cA + (size_t)(t + 1) * kstep;
            const char* a2 = last ? nA : cA + (size_t)(t + 2) * kstep; const char* b2 = last ? nB : cB + (size_t)(t + 2) * kstep;
            const char* a3 = a2 + kstep; const char* b3 = b2 + kstep;
            if (last && has_next) S.a_ready(nxt);
            PG8_LDB(B0, 0, 0); PG8_SCHED; PG8_LDA(At, 0, 0); PG8_STAGE(PG8_SA(1, 1), a1 + hstep, voffA);
            PG8_WAIT_L(8); PG8_BAR; PG8_WAIT_L(0); PG8_MMA(0, 0, At, B0); PG8_BAR; PG8_SCHED;
            PG8_LDB(B1, 0, 1); PG8_STAGE(PG8_SB(0, 0), b2, voffB);
            PG8_BAR; PG8_WAIT_L(0); PG8_MMA(0, 1, At, B1); PG8_BAR;
            PG8_LDA(At, 0, 1); PG8_STAGE(PG8_SA(0, 0), a2, voffA);
            PG8_BAR; PG8_WAIT_L(0); PG8_MMA(1, 0, At, B0); PG8_BAR; PG8_SCHED;
            PG8_STAGE(PG8_SB(0, 1), b2 + hstep, voffB);
            PG8_WAIT_V(6); PG8_BAR; PG8_MMA(1, 1, At, B1); PG8_BAR;
            PG8_LDB(B0, 1, 0); PG8_SCHED; PG8_LDA(At, 1, 0); PG8_STAGE(PG8_SA(0, 1), a2 + hstep, voffA);
            PG8_WAIT_L(8); PG8_BAR; PG8_WAIT_L(0); PG8_MMA(0, 0, At, B0); PG8_BAR; PG8_SCHED;
            PG8_LDB(B1, 1, 1); PG8_STAGE(PG8_SB(1, 0), b3, voffB);
            PG8_BAR; PG8_WAIT_L(0); PG8_MMA(0, 1, At, B1); PG8_BAR;
            PG8_LDA(At, 1, 1); PG8_STAGE(PG8_SA(1, 0), a3, voffA);
            PG8_BAR; PG8_WAIT_L(0); PG8_MMA(1, 0, At, B0); PG8_BAR; PG8_SCHED;
            PG8_STAGE(PG8_SB(1, 1), b3 + hstep, voffB);
            PG8_WAIT_V(6); PG8_BAR; PG8_MMA(1, 1, At, B1); PG8_BAR;
        }
        E(acc, cur, wr, wc, fr, fq); S.done(cur);
        if (!has_next) break;
#pragma unroll
        for (int a = 0; a < 2; ++a)
#pragma unroll
            for (int b = 0; b < 2; ++b)
#pragma unroll
                for (int m = 0; m < 4; ++m)
#pragma unroll
                    for (int n = 0; n < 2; ++n) acc[a][b][m][n] = (f32x4){0.f, 0.f, 0.f, 0.f};
        cur = nxt; cA = nA; cB = nB; ++ui;
    }
    PG8_WAIT_V(0);
    if (wr == 0) PG8_BAR;
    PG8_BAR;
#undef PG8_SA
#undef PG8_SB
#undef PG8_STAGE
#undef PG8_LDA
#undef PG8_LDB
#undef PG8_MMA
#undef PG8_WAIT_V
#undef PG8_WAIT_L
#undef PG8_BAR
#undef PG8_SCHED
}
}

typedef const f32x4 (&AccRef)[2][2][4][2];

struct EpiSwiglu {
    bf16_t* O; const float* ss;
    __device__ __forceinline__ void operator()(AccRef acc, const pg8::Unit& u, int wr, int wc, int fr, int fq) const {
        const int row0 = u.pm * 256 + wr * 64 + fr, col0 = u.pn * 128 + wc * 32 + 8 * fq;
#pragma unroll
        for (int ai = 0; ai < 2; ++ai)
#pragma unroll
            for (int m = 0; m < 4; ++m) {
                const int r = row0 + ai * 128 + m * 16;
                const float inv = rsqrtf(ss[r] * (1.0f / D) + NORM_EPS);
                f32x4 o[2];
#pragma unroll
                for (int n = 0; n < 2; ++n)
#pragma unroll
                    for (int j = 0; j < 4; ++j) { const float gt = acc[ai][0][m][n][j] * inv, up = acc[ai][1][m][n][j] * inv; o[n][j] = gt * sigmoidf_(gt) * up; }
                *(u32x4*)(O + (size_t)r * FF + col0) = pack8(o[0], o[1]);
            }
    }
};

struct EpiResid {
    const float* rin; float* rout; bf16_t* xb; float* ssout; float alpha;
    __device__ __forceinline__ void operator()(AccRef acc, const pg8::Unit& u, int wr, int wc, int fr, int fq) const {
        const int row0 = u.pm * 256 + wr * 64 + fr, col0 = u.pn * 256 + wc * 32 + 8 * fq;
#pragma unroll
        for (int ai = 0; ai < 2; ++ai)
#pragma unroll
            for (int m = 0; m < 4; ++m) {
                const int r = row0 + ai * 128 + m * 16; float sq = 0.f;
#pragma unroll
                for (int bj = 0; bj < 2; ++bj) {
                    const size_t off = (size_t)r * D + col0 + bj * 128;
                    const f32x4 a0 = *(const f32x4*)(rin + off), a1 = *(const f32x4*)(rin + off + 4);
                    const f32x4 v0 = a0 + alpha * acc[ai][bj][m][0], v1 = a1 + alpha * acc[ai][bj][m][1];
                    *(f32x4*)(rout + off) = v0; *(f32x4*)(rout + off + 4) = v1;
                    *(u32x4*)(xb + off) = pack8(v0, v1);
                    sq += (v0[0] * v0[0] + v0[1] * v0[1]) + (v0[2] * v0[2] + v0[3] * v0[3]) + (v1[0] * v1[0] + v1[1] * v1[1]) + (v1[2] * v1[2] + v1[3] * v1[3]);
                }
                sq += __shfl_xor(sq, 16); sq += __shfl_xor(sq, 32);
                if (fq == 0) atomicAdd(ssout + r, sq);
            }
    }
};

template <int MODE>
struct EpiInproj {
    bf16_t* P0; bf16_t* P1; int ld; int nplain; const float* ss;
    __device__ __forceinline__ void operator()(AccRef acc, const pg8::Unit& u, int wr, int wc, int fr, int fq) const {
        const int row0 = u.pm * 256 + wr * 64 + fr;
        if (u.pn < nplain) {
            const int col0 = u.pn * 256 + wc * 32 + 8 * fq;
#pragma unroll
            for (int ai = 0; ai < 2; ++ai)
#pragma unroll
                for (int m = 0; m < 4; ++m) {
                    const int r = row0 + ai * 128 + m * 16;
                    const float inv = rsqrtf(ss[r] * (1.0f / D) + NORM_EPS);
#pragma unroll
                    for (int bj = 0; bj < 2; ++bj) *(u32x4*)(P0 + (size_t)r * ld + col0 + bj * 128) = pack8(acc[ai][bj][m][0] * inv, acc[ai][bj][m][1] * inv);
                }
        } else {
            const int col0 = (u.pn - nplain) * 128 + wc * 32 + 8 * fq;
#pragma unroll
            for (int ai = 0; ai < 2; ++ai)
#pragma unroll
                for (int m = 0; m < 4; ++m) {
                    const int r = row0 + ai * 128 + m * 16;
                    const float inv = rsqrtf(ss[r] * (1.0f / D) + NORM_EPS);
                    f32x4 o[2];
#pragma unroll
                    for (int n = 0; n < 2; ++n)
#pragma unroll
                        for (int j = 0; j < 4; ++j) { const float a = acc[ai][0][m][n][j] * inv, b = acc[ai][1][m][n][j] * inv; o[n][j] = MODE == 0 ? a * sigmoidf_(b) : a * b; }
                    *(u32x4*)(P1 + (size_t)r * ld + col0) = pack8(o[0], o[1]);
                }
        }
    }
};

struct EpiEmb {
    bf16_t* E; float* sse;
    __device__ __forceinline__ void operator()(AccRef acc, const pg8::Unit& u, int wr, int wc, int fr, int fq) const {
        const int row0 = u.pm * 256 + wr * 64 + fr, col0 = u.pn * 256 + wc * 32 + 8 * fq;
#pragma unroll
        for (int ai = 0; ai < 2; ++ai)
#pragma unroll
            for (int m = 0; m < 4; ++m) {
                const int r = row0 + ai * 128 + m * 16; float sq = 0.f;
#pragma unroll
                for (int bj = 0; bj < 2; ++bj) {
                    const f32x4 v0 = acc[ai][bj][m][0], v1 = acc[ai][bj][m][1];
                    *(u32x4*)(E + (size_t)r * D + col0 + bj * 128) = pack8(v0, v1);
                    sq += (v0[0] * v0[0] + v0[1] * v0[1]) + (v0[2] * v0[2] + v0[3] * v0[3]) + (v1[0] * v1[0] + v1[1] * v1[1]) + (v1[2] * v1[2] + v1[3] * v1[3]);
                }
                sq += __shfl_xor(sq, 16); sq += __shfl_xor(sq, 32);
                if (fq == 0) atomicAdd(sse + r, sq);
            }
    }
};

struct EpiPle {
    const float* rin; float* rout; bf16_t* xb; float* ssout; const float* ssx; const float* sse; const bf16_t* E; const float* gpp;
    __device__ __forceinline__ void operator()(AccRef acc, const pg8::Unit& u, int wr, int wc, int fr, int fq) const {
        const int row0 = u.pm * 256 + wr * 64 + fr, col0 = u.pn * 256 + wc * 32 + 8 * fq;
        f32x4 gp[2][2];
#pragma unroll
        for (int bj = 0; bj < 2; ++bj) { gp[bj][0] = *(const f32x4*)(gpp + col0 + bj * 128); gp[bj][1] = *(const f32x4*)(gpp + col0 + bj * 128 + 4); }
#pragma unroll
        for (int ai = 0; ai < 2; ++ai)
#pragma unroll
            for (int m = 0; m < 4; ++m) {
                const int r = row0 + ai * 128 + m * 16; float sq = 0.f;
                const float invx = rsqrtf(ssx[r] * (1.0f / D) + NORM_EPS), inve = rsqrtf(sse[r] * (1.0f / D) + NORM_EPS);
#pragma unroll
                for (int bj = 0; bj < 2; ++bj) {
                    const size_t off = (size_t)r * D + col0 + bj * 128;
                    const f32x4 a0 = *(const f32x4*)(rin + off), a1 = *(const f32x4*)(rin + off + 4);
                    const u32x4 ew = *(const u32x4*)(E + off);
                    f32x4 e0 = (f32x4){bf_lo(ew.x), bf_hi(ew.x), bf_lo(ew.y), bf_hi(ew.y)}, e1 = (f32x4){bf_lo(ew.z), bf_hi(ew.z), bf_lo(ew.w), bf_hi(ew.w)};
                    f32x4 v0, v1;
#pragma unroll
                    for (int j = 0; j < 4; ++j) {
                        v0[j] = a0[j] + sigmoidf_(acc[ai][bj][m][0][j] * invx) * (e0[j] * inve * gp[bj][0][j]);
                        v1[j] = a1[j] + sigmoidf_(acc[ai][bj][m][1][j] * invx) * (e1[j] * inve * gp[bj][1][j]);
                    }
                    *(f32x4*)(rout + off) = v0; *(f32x4*)(rout + off + 4) = v1;
                    *(u32x4*)(xb + off) = pack8(v0, v1);
                    sq += (v0[0] * v0[0] + v0[1] * v0[1]) + (v0[2] * v0[2] + v0[3] * v0[3]) + (v1[0] * v1[0] + v1[1] * v1[1]) + (v1[2] * v1[2] + v1[3] * v1[3]);
                }
                sq += __shfl_xor(sq, 16); sq += __shfl_xor(sq, 32);
                if (fq == 0) atomicAdd(ssout + r, sq);
            }
    }
};

__device__ __forceinline__ int colmap(int mode, int n) {
    if (mode == 1) { const int pn = n >> 8, bj = (n >> 7) & 1, j = n & 127; return bj * FF + pn * 128 + j; }
    if (mode == 2) { if (n < 512) return n; const int q = n - 512, t = q >> 8, bj = (q >> 7) & 1, j = q & 127; return 512 + bj * 512 + t * 128 + j; }
    if (mode == 3) { if (n < 1024) return n; const int q = n - 1024, t = q >> 8, bj = (q >> 7) & 1, j = q & 127; return 1024 + bj * 1024 + t * 128 + j; }
    return n;
}
__device__ __forceinline__ void transpose_item(const float* W, int K, int ld, int N, bf16_t* WT, int mode, const float* scale, LAS float* scr, int item, int lane) {
    const int nblk = N / 32, kb = item / nblk, nb = item % nblk, k0 = 64 * kb, n0 = 32 * nb;
    const int c0 = colmap(mode, n0);
#pragma unroll 8
    for (int i = 0; i < 32; ++i) { const int kk = 2 * i + (lane >> 5); float v = W[(size_t)(k0 + kk) * ld + c0 + (lane & 31)]; if (scale) v *= scale[k0 + kk]; scr[kk * 33 + (lane & 31)] = v; }
    asm volatile("s_waitcnt lgkmcnt(0)" ::: "memory");
    const int c = lane & 7;
#pragma unroll
    for (int j = 0; j < 4; ++j) { const int n = (lane >> 3) + 8 * j; const LAS float* s = scr + (8 * c) * 33 + n;
        u32x4 o; o.x = cvt_pk_bf16(s[0 * 33], s[1 * 33]); o.y = cvt_pk_bf16(s[2 * 33], s[3 * 33]); o.z = cvt_pk_bf16(s[4 * 33], s[5 * 33]); o.w = cvt_pk_bf16(s[6 * 33], s[7 * 33]);
        *(u32x4*)(WT + (size_t)(n0 + n) * K + k0 + 8 * c) = o; }
    asm volatile("s_waitcnt lgkmcnt(0)" ::: "memory");
}

__device__ __forceinline__ void p0_prologue(KP pp, LAS unsigned char* lds) {
    const Params p = ldp(pp);
    int tid_ = threadIdx.x; LAUNDER_V(tid_);
    const int tid = tid_, lane = tid & 63, wave = __builtin_amdgcn_readfirstlane(tid >> 6);
    const int gw = blockIdx.x * 8 + wave, NGW = gridDim.x * 8;
    LAS float* scr = (LAS float*)(lds + wave * 16384);
    unsigned char* ws = p.ws;
    { float* ss = (float*)(ws + WS_SS); for (size_t i = (size_t)blockIdx.x * 512 + tid; i < (size_t)(NSS - 1) * M; i += (size_t)gridDim.x * 512) ss[M + i] = 0.f; }
    int it = gw, base = 0;
#define TJOB(src, K_, ld_, N_, dst, mode, scale) do { const int ni = ((K_) / 64) * ((N_) / 32); while (it < base + ni) { transpose_item((src), (K_), (ld_), (N_), (bf16_t*)(dst), (mode), (scale), scr, it - base, lane); it += NGW; } base += ni; } while (0)
    for (int lh = 0; lh < 4; ++lh) TJOB(p.in[8] + (size_t)lh * D * 2 * FF, D, 2 * FF, 2 * FF, ws + WS_WGU + lh * SZ_WGU, 1, p.in[7] + lh * D);
    for (int lh = 0; lh < 4; ++lh) TJOB(p.in[9] + (size_t)lh * FF * D, FF, D, D, ws + WS_WD + lh * SZ_WD, 0, (const float*)nullptr);
    TJOB(p.in[11], D, 1536, 1536, ws + WS_WINE, 2, p.in[10]);
    TJOB(p.in[18], D, D, D, ws + WS_WOUTE, 0, (const float*)nullptr);
    TJOB(p.in[19], D, 3072, 3072, ws + WS_WINO, 3, p.in[10] + D);
    TJOB(p.in[21], D, D, D, ws + WS_WOUTO, 0, (const float*)nullptr);
    for (int l = 0; l < 2; ++l) TJOB(p.in[23] + (size_t)l * D * D, D, D, D, ws + WS_WPG + (size_t)l * D * D * 2, 0, p.in[22] + l * D);
    for (int l = 0; l < 2; ++l) TJOB(p.in[24] + (size_t)l * PLE * D, PLE, D, D, ws + WS_WPP + (size_t)l * D * PLE * 2, 0, (const float*)nullptr);
    for (int g = 0; g < 4; ++g) TJOB(p.in[12] + (size_t)g * 128 * 128, 128, 128, 128, ws + WS_POOLP + (size_t)g * 128 * 128 * 2, 0, (const float*)nullptr);
#undef TJOB
    {
        float* ss0 = (float*)(ws + WS_SS); bf16_t* xb = (bf16_t*)(ws + WS_XB);
        for (int r = gw; r < M; r += NGW) {
            const float* src = r < MP ? p.in[0] + (size_t)r * D : p.in[1] + (size_t)(r - MP) * D;
            float s = 0.f;
#pragma unroll
            for (int j = 0; j < 4; ++j) {
                const f32x4 v = *(const f32x4*)(src + 4 * lane + 256 * j);
                *(f32x4*)(p.out + O_Y + (size_t)r * D + 4 * lane + 256 * j) = v;
                u32x2 w; w.x = cvt_pk_bf16(v[0], v[1]); w.y = cvt_pk_bf16(v[2], v[3]);
                *(u32x2*)(xb + (size_t)r * D + 4 * lane + 256 * j) = w;
                s += (v[0] * v[0] + v[1] * v[1]) + (v[2] * v[2] + v[3] * v[3]);
            }
            s = wave_sum(s);
            if (lane == 0) ss0[r] = s;
        }
    }
    {
        bf16_t* pb = (bf16_t*)(ws + WS_PB);
        for (int q = gw; q < 2 * M; q += NGW) {
            const int l = q / M, r = q - l * M;
            const float* src = r < MP ? p.in[5] + ((size_t)l * MP + r) * PLE : p.in[6] + ((size_t)l * MS + (r - MP)) * PLE;
            const f32x4 v = *(const f32x4*)(src + 4 * lane);
            u32x2 w; w.x = cvt_pk_bf16(v[0], v[1]); w.y = cvt_pk_bf16(v[2], v[3]);
            *(u32x2*)(pb + ((size_t)l * M + r) * PLE + 4 * lane) = w;
        }
    }
}

constexpr int ET = 32;
constexpr int PB_LD = 520;
__device__ __forceinline__ void e4_even(KP pp, LAS unsigned char* lds) {
    const Params p = ldp(pp);
    int tid_ = threadIdx.x; LAUNDER_V(tid_);
    const int tid = tid_, lane = tid & 63, wave = __builtin_amdgcn_readfirstlane(tid >> 6);
    unsigned char* ws = p.ws;
    const bf16_t* xa = (const bf16_t*)(ws + WS_PROJ);
    const bf16_t* ub = (const bf16_t*)(ws + WS_PROJ + (size_t)M * 512 * 2);
    bf16_t* cat = (bf16_t*)(ws + WS_ACT);
    const bf16_t* poolp = (const bf16_t*)(ws + WS_POOLP);
    const float* st_pool = p.in[2]; const float* st_dw = p.in[3];
    const float* pool_scale = p.in[13]; const float* dw_w = p.in[14]; const float* dw_b = p.in[15]; const float* ln_g = p.in[16]; const float* ln_b = p.in[17];
    LAS float* convbuf = (LAS float*)lds;
    LAS bf16_t* poolbuf = (LAS bf16_t*)(lds + 65536);
    for (int tile = blockIdx.x; tile < M / ET; tile += gridDim.x) {
        const int r0 = tile * ET; const bool samp = r0 >= MP;
        const int nseg = samp ? ET / DSEQ : 1, seglen = samp ? DSEQ : ET;
        if (wave < 4) {
            const int c0 = 128 * wave + 2 * lane;
            f32x2 wk[31];
#pragma unroll
            for (int k = 0; k < 31; ++k) wk[k] = *(const f32x2*)(dw_w + k * 512 + c0);
            const f32x2 bias = *(const f32x2*)(dw_b + c0);
            for (int seg = 0; seg < nseg; ++seg) {
                const int rs = r0 + seg * seglen;
                f32x2 win[30];
                int t0 = 0, bq = 0;
                if (samp) {
                    bq = (rs - MP) / DSEQ;
#pragma unroll
                    for (int j = 0; j < 30; ++j) win[j] = *(const f32x2*)(st_dw + ((size_t)bq * 30 + j) * 512 + c0);
#pragma unroll
                    for (int j = 0; j < 22; ++j) *(f32x2*)(p.out + O_DW_S + ((size_t)bq * 30 + j) * 512 + c0) = win[8 + j];
                } else {
                    t0 = rs % SEQ; bq = rs / SEQ;
#pragma unroll
                    for (int j = 0; j < 30; ++j) { const int t = t0 - 30 + j; f32x2 v = (f32x2){0.f, 0.f};
                        if (t >= 0) { const unsigned w = *(const unsigned*)(ub + (size_t)(rs - 30 + j) * 512 + c0); v = (f32x2){bf_lo(w), bf_hi(w)}; }
                        win[j] = v; }
                }
                for (int i = 0; i < seglen; ++i) {
                    const unsigned w = *(const unsigned*)(ub + (size_t)(rs + i) * 512 + c0);
                    const f32x2 cur = (f32x2){bf_lo(w), bf_hi(w)};
                    f32x2 a = bias + wk[30] * cur;
#pragma unroll
                    for (int k = 0; k < 30; ++k) a += wk[k] * win[k];
                    *(LAS f32x2*)(convbuf + (seg * seglen + i) * 512 + c0) = a;
#pragma unroll
                    for (int k = 0; k < 29; ++k) win[k] = win[k + 1];
                    win[29] = cur;
                    if (samp) *(f32x2*)(p.out + O_DW_S + ((size_t)bq * 30 + 22 + i) * 512 + c0) = cur;
                    else if (t0 + i >= SEQ - 30) *(f32x2*)(p.out + O_DW_P + ((size_t)bq * 30 + (t0 + i - (SEQ - 30))) * 512 + c0) = cur;
                }
            }
        } else {
            const int g = wave - 4, c0 = 128 * g + 2 * lane, W = 2 << g;
            for (int seg = 0; seg < nseg; ++seg) {
                const int rs = r0 + seg * seglen;
                f32x2 win[15];
                int t0 = 0, bq = 0;
                if (samp) {
                    bq = (rs - MP) / DSEQ;
#pragma unroll
                    for (int j = 0; j < 15; ++j) win[j] = *(const f32x2*)(st_pool + ((size_t)bq * 15 + j) * 512 + c0);
#pragma unroll
                    for (int j = 0; j < 7; ++j) *(f32x2*)(p.out + O_POOL_S + ((size_t)bq * 15 + j) * 512 + c0) = win[8 + j];
                } else {
                    t0 = rs % SEQ; bq = rs / SEQ;
#pragma unroll
                    for (int j = 0; j < 15; ++j) { const int t = t0 - 15 + j; f32x2 v = (f32x2){0.f, 0.f};
                        if (t >= 0) { const unsigned w = *(const unsigned*)(xa + (size_t)(rs - 15 + j) * 512 + c0); v = (f32x2){bf_lo(w), bf_hi(w)}; }
                        win[j] = v; }
                }
                for (int i = 0; i < seglen; ++i) {
                    const unsigned w = *(const unsigned*)(xa + (size_t)(rs + i) * 512 + c0);
                    const f32x2 cur = (f32x2){bf_lo(w), bf_hi(w)};
                    const f32x2 s2 = cur + win[14];
                    const f32x2 s4 = s2 + (win[13] + win[12]);
                    const f32x2 s8 = s4 + ((win[11] + win[10]) + (win[9] + win[8]));
                    const f32x2 s16 = s8 + (((win[7] + win[6]) + (win[5] + win[4])) + ((win[3] + win[2]) + (win[1] + win[0])));
                    const f32x2 sm = g == 0 ? s2 : (g == 1 ? s4 : (g == 2 ? s8 : s16));
                    const int pos = samp ? (PAST + i) : (t0 + i);
                    const int cnt = (pos + 1) < W ? (pos + 1) : W;
                    const float rc = 1.0f / (float)cnt;
                    const f32x2 pl = sm * rc - cur;
                    *(LAS unsigned*)(poolbuf + (seg * seglen + i) * PB_LD + c0) = cvt_pk_bf16(pl[0], pl[1]);
#pragma unroll
                    for (int k = 0; k < 14; ++k) win[k] = win[k + 1];
                    win[14] = cur;
                    if (samp) *(f32x2*)(p.out + O_POOL_S + ((size_t)bq * 15 + 7 + i) * 512 + c0) = cur;
                    else if (t0 + i >= SEQ - 15) *(f32x2*)(p.out + O_POOL_P + ((size_t)bq * 15 + (t0 + i - (SEQ - 15))) * 512 + c0) = cur;
                }
            }
        }
        __syncthreads();
        {
            f32x2 gg[4], bb[4];
#pragma unroll
            for (int i = 0; i < 4; ++i) { gg[i] = *(const f32x2*)(ln_g + 2 * lane + 128 * i); bb[i] = *(const f32x2*)(ln_b + 2 * lane + 128 * i); }
            for (int q = 0; q < 4; ++q) {
                const int row = wave * 4 + q;
                f32x2 v[4]; float s = 0.f;
#pragma unroll
                for (int i = 0; i < 4; ++i) { v[i] = *(const LAS f32x2*)(convbuf + row * 512 + 2 * lane + 128 * i); s += v[i][0] + v[i][1]; }
                const float mean = wave_sum(s) * (1.0f / 512.0f); float s2 = 0.f;
#pragma unroll
                for (int i = 0; i < 4; ++i) { v[i] = v[i] - mean; s2 += v[i][0] * v[i][0] + v[i][1] * v[i][1]; }
                const float rstd = rsqrtf(wave_sum(s2) * (1.0f / 512.0f) + LN_EPS);
#pragma unroll
                for (int i = 0; i < 4; ++i) { const f32x2 y = v[i] * rstd * gg[i] + bb[i];
                    *(unsigned*)(cat + (size_t)(r0 + row) * D + 512 + 2 * lane + 128 * i) = cvt_pk_bf16(y[0] * sigmoidf_(y[0]), y[1] * sigmoidf_(y[1])); }
            }
        }
        {
            const int g = wave >> 1, nh = wave & 1, fr = lane & 15, fq = lane >> 4;
            bf16x8 Af[2][4];
#pragma unroll
            for (int mt = 0; mt < 2; ++mt)
#pragma unroll
                for (int ks = 0; ks < 4; ++ks) Af[mt][ks] = *(const LAS bf16x8*)(poolbuf + (mt * 16 + fr) * PB_LD + g * 128 + ks * 32 + fq * 8);
#pragma unroll
            for (int nt_ = 0; nt_ < 4; ++nt_) {
                const int dcol = nh * 64 + nt_ * 16;
                bf16x8 Bf[4];
#pragma unroll
                for (int ks = 0; ks < 4; ++ks) Bf[ks] = *(const bf16x8*)(poolp + ((size_t)(g * 128 + dcol + fr)) * 128 + ks * 32 + fq * 8);
                const f32x4 sc = *(const f32x4*)(pool_scale + g * 128 + dcol + 4 * fq);
#pragma unroll
                for (int mt = 0; mt < 2; ++mt) {
                    f32x4 a = (f32x4){0.f, 0.f, 0.f, 0.f};
#pragma unroll
                    for (int ks = 0; ks < 4; ++ks) a = __builtin_amdgcn_mfma_f32_16x16x32_bf16(Bf[ks], Af[mt][ks], a, 0, 0, 0);
                    a = a * sc;
                    u32x2 w; w.x = cvt_pk_bf16(a[0], a[1]); w.y = cvt_pk_bf16(a[2], a[3]);
                    *(u32x2*)(cat + (size_t)(r0 + mt * 16 + fr) * D + g * 128 + dcol + 4 * fq) = w;
                }
            }
        }
        __syncthreads();
    }
}

__device__ __forceinline__ void e4_odd(KP pp) {
    const Params p = ldp(pp);
    unsigned char* ws = p.ws;
    const bf16_t* gb = (const bf16_t*)(ws + WS_PROJ);
    const bf16_t* sb = (const bf16_t*)(ws + WS_PROJ + (size_t)M * D * 2);
    bf16_t* cat = (bf16_t*)(ws + WS_ACT);
    const float* st_sc = p.in[4]; const float* scw = p.in[20];
    for (size_t it = (size_t)blockIdx.x * 512 + threadIdx.x; it < (size_t)M * 128; it += (size_t)gridDim.x * 512) {
        const int r = (int)(it >> 7), c = (int)(it & 127) * 8;
        const bool samp = r >= MP;
        const int t = samp ? (r - MP) % DSEQ : r % SEQ;
        const int bq = samp ? (r - MP) / DSEQ : r / SEQ;
        float s0[8], s1[8], s2[8], gv[8];
        { const u32x4 w = *(const u32x4*)(sb + (size_t)r * D + c); s2[0] = bf_lo(w.x); s2[1] = bf_hi(w.x); s2[2] = bf_lo(w.y); s2[3] = bf_hi(w.y); s2[4] = bf_lo(w.z); s2[5] = bf_hi(w.z); s2[6] = bf_lo(w.w); s2[7] = bf_hi(w.w); }
        { const u32x4 w = *(const u32x4*)(gb + (size_t)r * D + c); gv[0] = bf_lo(w.x); gv[1] = bf_hi(w.x); gv[2] = bf_lo(w.y); gv[3] = bf_hi(w.y); gv[4] = bf_lo(w.z); gv[5] = bf_hi(w.z); gv[6] = bf_lo(w.w); gv[7] = bf_hi(w.w); }
        if (t >= 1) { const u32x4 w = *(const u32x4*)(sb + (size_t)(r - 1) * D + c); s1[0] = bf_lo(w.x); s1[1] = bf_hi(w.x); s1[2] = bf_lo(w.y); s1[3] = bf_hi(w.y); s1[4] = bf_lo(w.z); s1[5] = bf_hi(w.z); s1[6] = bf_lo(w.w); s1[7] = bf_hi(w.w); }
        else if (samp) { const f32x4 a = *(const f32x4*)(st_sc + ((size_t)bq * 2 + 1) * D + c), b = *(const f32x4*)(st_sc + ((size_t)bq * 2 + 1) * D + c + 4);
#pragma unroll
            for (int j = 0; j < 4; ++j) { s1[j] = a[j]; s1[4 + j] = b[j]; } }
        else {
#pragma unroll
            for (int j = 0; j < 8; ++j) s1[j] = 0.f; }
        if (t >= 2) { const u32x4 w = *(const u32x4*)(sb + (size_t)(r - 2) * D + c); s0[0] = bf_lo(w.x); s0[1] = bf_hi(w.x); s0[2] = bf_lo(w.y); s0[3] = bf_hi(w.y); s0[4] = bf_lo(w.z); s0[5] = bf_hi(w.z); s0[6] = bf_lo(w.w); s0[7] = bf_hi(w.w); }
        else if (samp) { const int pr = t;
            const f32x4 a = *(const f32x4*)(st_sc + ((size_t)bq * 2 + pr) * D + c), b = *(const f32x4*)(st_sc + ((size_t)bq * 2 + pr) * D + c + 4);
#pragma unroll
            for (int j = 0; j < 4; ++j) { s0[j] = a[j]; s0[4 + j] = b[j]; } }
        else {
#pragma unroll
            for (int j = 0; j < 8; ++j) s0[j] = 0.f; }
        float w0[8], w1[8], w2[8];
        { const f32x4 a = *(const f32x4*)(scw + c), b = *(const f32x4*)(scw + c + 4), a1 = *(const f32x4*)(scw + D + c), b1 = *(const f32x4*)(scw + D + c + 4), a2 = *(const f32x4*)(scw + 2 * D + c), b2 = *(const f32x4*)(scw + 2 * D + c + 4);
#pragma unroll
            for (int j = 0; j < 4; ++j) { w0[j] = a[j]; w0[4 + j] = b[j]; w1[j] = a1[j]; w1[4 + j] = b1[j]; w2[j] = a2[j]; w2[4 + j] = b2[j]; } }
        float o[8];
#pragma unroll
        for (int j = 0; j < 8; ++j) o[j] = gv[j] * (w0[j] * s0[j] + w1[j] * s1[j] + w2[j] * s2[j]);
        u32x4 ow; ow.x = cvt_pk_bf16(o[0], o[1]); ow.y = cvt_pk_bf16(o[2], o[3]); ow.z = cvt_pk_bf16(o[4], o[5]); ow.w = cvt_pk_bf16(o[6], o[7]);
        *(u32x4*)(cat + (size_t)r * D + c) = ow;
        const int L = samp ? DSEQ : SEQ;
        if (t >= L - 2) {
            float* dst = p.out + (samp ? O_SC_S : O_SC_P) + ((size_t)bq * 2 + (t - (L - 2))) * D + c;
            *(f32x4*)dst = (f32x4){s2[0], s2[1], s2[2], s2[3]}; *(f32x4*)(dst + 4) = (f32x4){s2[4], s2[5], s2[6], s2[7]};
        }
    }
}

__device__ __forceinline__ void e9_final(KP pp) {
    const Params p = ldp(pp);
    int tid_ = threadIdx.x; LAUNDER_V(tid_);
    const int tid = tid_, lane = tid & 63, wave = __builtin_amdgcn_readfirstlane(tid >> 6);
    const int gw = blockIdx.x * 8 + wave, NGW = gridDim.x * 8;
    const float* ss = (const float*)(p.ws + WS_SS) + (size_t)8 * M;
    const float* gf = p.in[26];
    f32x4 gv[4];
#pragma unroll
    for (int j = 0; j < 4; ++j) gv[j] = *(const f32x4*)(gf + 4 * lane + 256 * j);
    for (int r = gw; r < M; r += NGW) {
        const float inv = rsqrtf(ss[r] * (1.0f / D) + NORM_EPS);
        float* row = p.out + O_Y + (size_t)r * D;
#pragma unroll
        for (int j = 0; j < 4; ++j) { const f32x4 v = *(const f32x4*)(row + 4 * lane + 256 * j); *(f32x4*)(row + 4 * lane + 256 * j) = v * inv * gv[j]; }
    }
}

constexpr int NPHASE = 18;
#ifndef PHMASK
#define PHMASK 0x3ffff
#endif
template <int L>
__device__ __forceinline__ void layer_phases(KP kp, LAS unsigned char* lds, const int ph_lo, const int ph_hi) {
    constexpr int pb0 = 1 + 8 * L;
    const bool multi = (ph_hi - ph_lo) > 1;
#define SYNC_IF(k) do { if (multi && (k) + 1 < ph_hi) cg::this_grid().sync(); } while (0)
#define IN(k) (((PHMASK >> (k)) & 1) && ph_lo <= (k) && (k) < ph_hi)
#define PHASE_VARS KP pp = kp; LAUNDER_S(pp); unsigned char* ws = pp->ws; float* ssb = (float*)(ws + WS_SS); bf16_t* xb = (bf16_t*)(ws + WS_XB); bf16_t* act = (bf16_t*)(ws + WS_ACT); \
    float* xres = pp->out + O_Y; const int G = gridDim.x, bid = blockIdx.x; (void)ssb; (void)xb; (void)act; (void)xres;
    if (IN(pb0 + 0)) {
        { PHASE_VARS
          pg8::Gemm g{L == 0 ? xb : (const bf16_t*)(ws + WS_PROJ)  , (const bf16_t*)(ws + WS_WGU + (size_t)(2 * L) * SZ_WGU), M, 2 * FF, D}; pg8::StaticOrder S; S.init(M, 2 * FF, G, bid);
          EpiSwiglu E{act, ssb + (size_t)(4 * L) * M}; pg8::gemm_phase(lds, g, S, E); }
        { PHASE_VARS
          pg8::Gemm g{(const bf16_t*)(ws + WS_PB) + (size_t)L * M * PLE, (const bf16_t*)(ws + WS_WPP + (size_t)L * D * PLE * 2), M, D, PLE}; pg8::StaticOrder S; S.init(M, D, G, bid);
          EpiEmb E{(bf16_t*)(ws + WS_E), ssb + (size_t)(9 + L) * M}; pg8::gemm_phase(lds, g, S, E); }
        SYNC_IF(pb0 + 0);
    }
    if (IN(pb0 + 1)) {
        { PHASE_VARS
          pg8::Gemm g{act, (const bf16_t*)(ws + WS_WD + (size_t)(2 * L) * SZ_WD), M, D, FF}; pg8::StaticOrder S; S.init(M, D, G, bid);
          EpiResid E{xres, xres, xb, ssb + (size_t)(4 * L + 1) * M, 0.5f}; pg8::gemm_phase(lds, g, S, E); }
        SYNC_IF(pb0 + 1);
    }
    if (IN(pb0 + 2)) {
        { PHASE_VARS
          if (L == 0) { pg8::Gemm g{xb, (const bf16_t*)(ws + WS_WINE), M, 1536, D}; pg8::StaticOrder S; S.init(M, 1536, G, bid);
              EpiInproj<0> E{(bf16_t*)(ws + WS_PROJ), (bf16_t*)(ws + WS_PROJ + (size_t)M * 512 * 2), 512, 2, ssb + (size_t)(4 * L + 1) * M}; pg8::gemm_phase(lds, g, S, E); }
          else { pg8::Gemm g{xb, (const bf16_t*)(ws + WS_WINO), M, 3072, D}; pg8::StaticOrder S; S.init(M, 3072, G, bid);
              EpiInproj<1> E{(bf16_t*)(ws + WS_PROJ), (bf16_t*)(ws + WS_PROJ + (size_t)M * D * 2), D, 4, ssb + (size_t)(4 * L + 1) * M}; pg8::gemm_phase(lds, g, S, E); } }
        SYNC_IF(pb0 + 2);
    }
    if (IN(pb0 + 3)) {
        { KP pp = kp; LAUNDER_S(pp); if (L == 0) e4_even(pp, lds); else e4_odd(pp); }
        SYNC_IF(pb0 + 3);
    }
    if (IN(pb0 + 4)) {
        { PHASE_VARS
          pg8::Gemm g{act  , (const bf16_t*)(ws + (L == 0 ? WS_WOUTE : WS_WOUTO)), M, D, D}; pg8::StaticOrder S; S.init(M, D, G, bid);
          EpiResid E{xres, xres, xb, ssb + (size_t)(4 * L + 2) * M, 1.0f}; pg8::gemm_phase(lds, g, S, E); }
        SYNC_IF(pb0 + 4);
    }
    if (IN(pb0 + 5)) {
        { PHASE_VARS
          pg8::Gemm g{xb, (const bf16_t*)(ws + WS_WGU + (size_t)(2 * L + 1) * SZ_WGU), M, 2 * FF, D}; pg8::StaticOrder S; S.init(M, 2 * FF, G, bid);
          EpiSwiglu E{act, ssb + (size_t)(4 * L + 2) * M}; pg8::gemm_phase(lds, g, S, E); }
        SYNC_IF(pb0 + 5);
    }
    if (IN(pb0 + 6)) {
        { PHASE_VARS
          pg8::Gemm g{act, (const bf16_t*)(ws + WS_WD + (size_t)(2 * L + 1) * SZ_WD), M, D, FF}; pg8::StaticOrder S; S.init(M, D, G, bid);
          EpiResid E{xres, xres, xb, ssb + (size_t)(4 * L + 3) * M, 0.5f}; pg8::gemm_phase(lds, g, S, E); }
        SYNC_IF(pb0 + 6);
    }
    if (IN(pb0 + 7)) {
        { PHASE_VARS
          pg8::Gemm g{xb, (const bf16_t*)(ws + WS_WPG + (size_t)L * D * D * 2), M, D, D}; pg8::StaticOrder S; S.init(M, D, G, bid);
          EpiPle E{xres, xres, (bf16_t*)(ws + WS_PROJ)  , ssb + (size_t)(4 * L + 4) * M, ssb + (size_t)(4 * L + 3) * M, ssb + (size_t)(9 + L) * M, (const bf16_t*)(ws + WS_E), pp->in[25] + L * D}; pg8::gemm_phase(lds, g, S, E); }
        SYNC_IF(pb0 + 7);
    }
}
__global__ void __launch_bounds__(512, 2) fwd_kernel(Params p) {
    extern __shared__ __attribute__((aligned(16))) unsigned char shm[];
    LAS unsigned char* lds = (LAS unsigned char*)shm;
    KP kp = (KP)__builtin_amdgcn_kernarg_segment_ptr();
    const int ph_lo = p.ph_lo, ph_hi = p.ph_hi;
    const bool multi = (ph_hi - ph_lo) > 1;
    if (IN(0)) { { KP pp = kp; LAUNDER_S(pp); p0_prologue(pp, lds); } __syncthreads(); SYNC_IF(0); }
    layer_phases<0>(kp, lds, ph_lo, ph_hi);
    layer_phases<1>(kp, lds, ph_lo, ph_hi);
    if (IN(17)) { KP pp = kp; LAUNDER_S(pp); e9_final(pp); }
#undef IN
#undef SYNC_IF
}

extern "C" void kernel_launch(void* const* d_in, const int* in_sizes, int n_in, void* d_out, int out_size, void* d_ws, size_t ws_size, hipStream_t stream) {
    static int grid = 0;
    if (grid == 0) {
        if (n_in != 27 || (size_t)out_size != O_END || ws_size < WS_END) { fprintf(stderr, "kernel_launch: shape/workspace mismatch (n_in %d out %d ws %zu need %zu)\n", n_in, out_size, ws_size, (size_t)WS_END); grid = -1; return; }
        int dev = 0, cus = 0;
        if (hipGetDevice(&dev) != hipSuccess || hipDeviceGetAttribute(&cus, hipDeviceAttributeMultiprocessorCount, dev) != hipSuccess) { grid = -1; return; }
        if (hipFuncSetAttribute((const void*)fwd_kernel, hipFuncAttributeMaxDynamicSharedMemorySize, LDS_BYTES) != hipSuccess) { fprintf(stderr, "kernel_launch: hipFuncSetAttribute failed\n"); grid = -1; return; }
        int per_cu = 0;
        if (hipOccupancyMaxActiveBlocksPerMultiprocessor(&per_cu, (const void*)fwd_kernel, 512, LDS_BYTES) != hipSuccess || per_cu < 1) { fprintf(stderr, "kernel_launch: occupancy query says %d\n", per_cu); per_cu = 1; }
        (void)hipGetLastError();
        grid = cus;
    }
    if (grid < 0) return;
    Params p; memset(&p, 0, sizeof(p));
    for (int i = 0; i < 27; ++i) p.in[i] = (const float*)d_in[i];
    p.out = (float*)d_out; p.ws = (unsigned char*)d_ws;
#if MULTI_LAUNCH
    for (int k = 0; k < NPHASE; ++k) { p.ph_lo = k; p.ph_hi = k + 1; hipLaunchKernelGGL(fwd_kernel, dim3(grid), dim3(512), LDS_BYTES, stream, p); }
#else
    p.ph_lo = 0; p.ph_hi = NPHASE;
    void* args[] = {&p};
    hipError_t e = hipLaunchCooperativeKernel((const void*)fwd_kernel, dim3(grid), dim3(512), args, LDS_BYTES, stream);
    if (e != hipSuccess) fprintf(stderr, "cooperative launch failed: %s (grid %d)\n", hipGetErrorString(e), grid);
#endif
}
```
